# Optimizing an MI355X kernel written in HIP

```python
import jax, jax.numpy as jnp
from jax import lax
import numpy as np

D_MODEL = 1024
BATCH = 8
SEQ = 2048
DEPTH = 1

D_PLE = 256
N_ATTN_HEADS = 8
HEAD_DIM = 64
D_ATTN = N_ATTN_HEADS * HEAD_DIM
N_GMLP_GROUPS = 8
GMLP_GROUP_DIM = 64
D_GMLP = N_GMLP_GROUPS * GMLP_GROUP_DIM
D_MIX = D_ATTN + D_GMLP
D_IN_PROJ = 3 * D_ATTN + 2 * D_GMLP
D_FF = 4 * D_MODEL
MOBA_BLOCK = 256
MOBA_TOPK = 3
Q_CHUNK = 128
GMLP_CHUNK = 128
ROPE_THETA = 500000.0
ROPE_DIM = HEAD_DIM // 4
NORM_EPS = 1e-6
NEG_INF = -1e30

kernel_name = "hymba_moba_gmlp_hybrid_layer"


def rms_norm(x, g):
    xf = x.astype(jnp.float32)
    y = xf * lax.rsqrt(jnp.mean(xf * xf, axis=-1, keepdims=True) + NORM_EPS)
    return (y * g.astype(jnp.float32)).astype(x.dtype)


def layer_norm(x, g, b):
    xf = x.astype(jnp.float32)
    mu = jnp.mean(xf, axis=-1, keepdims=True)
    xc = xf - mu
    var = jnp.mean(xc * xc, axis=-1, keepdims=True)
    y = xc * lax.rsqrt(var + NORM_EPS) * g.astype(jnp.float32) + b.astype(jnp.float32)
    return y.astype(x.dtype)


def partial_rope(x, pos):
    half = ROPE_DIM // 2
    inv_freq = ROPE_THETA ** (-jnp.arange(half, dtype=jnp.float32) / half)
    ang = pos.astype(jnp.float32)[:, None] * inv_freq[None, :]
    cos = jnp.cos(ang)[None, :, None, :]
    sin = jnp.sin(ang)[None, :, None, :]
    xr = x[..., :ROPE_DIM].astype(jnp.float32)
    x1, x2 = xr[..., :half], xr[..., half:]
    rot = jnp.concatenate([x1 * cos - x2 * sin, x2 * cos + x1 * sin], axis=-1)
    return jnp.concatenate([rot.astype(x.dtype), x[..., ROPE_DIM:]], axis=-1)


def moba_attention(q, k, v):
    B, S, H, Dh = q.shape
    nb = -(-S // MOBA_BLOCK)
    pad = nb * MOBA_BLOCK - S
    k_p = jnp.pad(k, ((0, 0), (0, pad), (0, 0), (0, 0)))
    v_p = jnp.pad(v, ((0, 0), (0, pad), (0, 0), (0, 0)))
    k_blk = k_p.reshape(B, nb, MOBA_BLOCK, H, Dh).transpose(0, 3, 1, 2, 4)
    v_blk = v_p.reshape(B, nb, MOBA_BLOCK, H, Dh).transpose(0, 3, 1, 2, 4)

    k_mean = jnp.mean(k_blk.astype(jnp.float32), axis=3)
    pos = jnp.arange(S)
    own_blk = pos // MOBA_BLOCK
    gate = jnp.einsum('bshd,bhnd->bhsn', q.astype(jnp.float32), k_mean)
    past = jnp.arange(nb)[None, :] < own_blk[:, None]
    gate = jnp.where(past[None, None], gate, NEG_INF)
    topk = min(MOBA_TOPK, nb)
    _, sel = lax.top_k(gate, topk)
    sel_valid = sel < own_blk[:, None]

    scale = HEAD_DIM ** -0.5
    n_qc = S // Q_CHUNK
    qs = q * scale
    q_c = qs.reshape(B, n_qc, Q_CHUNK, H, Dh).transpose(0, 1, 3, 2, 4).reshape(B * n_qc, H, Q_CHUNK, Dh)
    sel_c = sel.reshape(B, H, n_qc, Q_CHUNK, topk).transpose(0, 2, 1, 3, 4).reshape(B * n_qc, H, Q_CHUNK, topk)
    val_c = sel_valid.reshape(B, H, n_qc, Q_CHUNK, topk).transpose(0, 2, 1, 3, 4).reshape(B * n_qc, H, Q_CHUNK, topk)
    b_idx = jnp.repeat(jnp.arange(B, dtype=jnp.int32), n_qc)
    c_idx = jnp.tile(jnp.arange(n_qc, dtype=jnp.int32), B)
    h_ix = jnp.arange(H)[:, None, None]
    n_sel = topk * MOBA_BLOCK

    def query_block(args):
        b, c, qc, selc, validc = args
        kb = k_blk[b]
        vb = v_blk[b]
        k_sel = kb[h_ix, selc]
        v_sel = vb[h_ix, selc]
        s_sel = jnp.einsum('hqd,hqnld->hqnl', qc, k_sel).astype(jnp.float32)
        s_sel = jnp.where(validc[..., None], s_sel, NEG_INF).reshape(H, Q_CHUNK, n_sel)
        i = (c * Q_CHUNK) // MOBA_BLOCK
        k_own = kb[:, i]
        v_own = vb[:, i]
        q_pos = c * Q_CHUNK + jnp.arange(Q_CHUNK)
        k_pos = i * MOBA_BLOCK + jnp.arange(MOBA_BLOCK)
        s_own = jnp.einsum('hqd,hld->hql', qc, k_own).astype(jnp.float32)
        s_own = jnp.where(k_pos[None, None, :] <= q_pos[None, :, None], s_own, NEG_INF)
        probs = jax.nn.softmax(jnp.concatenate([s_sel, s_own], axis=-1), axis=-1).astype(v.dtype)
        p_sel = probs[..., :n_sel].reshape(H, Q_CHUNK, topk, MOBA_BLOCK)
        p_own = probs[..., n_sel:]
        return (jnp.einsum('hqnl,hqnld->hqd', p_sel, v_sel)
                + jnp.einsum('hql,hld->hqd', p_own, v_own))

    o = lax.map(query_block, (b_idx, c_idx, q_c, sel_c, val_c))
    return o.reshape(B, n_qc, H, Q_CHUNK, Dh).transpose(0, 1, 3, 2, 4).reshape(B, S, H * Dh)


def gmlp_spatial_gating(u, gv, ln_g, ln_b, w_s, b_s):
    B, S, _ = gv.shape
    vn = layer_norm(gv, ln_g, ln_b)
    nc = S // GMLP_CHUNK
    vc = vn.reshape(B, nc, GMLP_CHUNK, N_GMLP_GROUPS, GMLP_GROUP_DIM)
    causal = jnp.tril(jnp.ones((GMLP_CHUNK, GMLP_CHUNK), dtype=bool))
    w = jnp.where(causal[None], w_s, 0.0)
    mixed = jnp.einsum('gts,bcsgd->bctgd', w, vc) + b_s.T[None, None, :, :, None]
    return u * mixed.reshape(B, S, D_GMLP)


def setup_inputs(seed: int = 0) -> dict:
    key = jax.random.key(seed)
    ks = jax.random.split(key, 20)
    f32 = jnp.float32

    def nrm(k, shape, scale):
        return jax.random.normal(k, shape, f32) * scale

    def gain(k, shape):
        return 1.0 + 0.05 * jax.random.normal(k, shape, f32)

    return {
        "x": jax.random.normal(ks[0], (BATCH, SEQ, D_MODEL), f32),
        "p": jax.random.normal(ks[1], (DEPTH, BATCH, SEQ, D_PLE), f32),
        "mix_pre_g": gain(ks[2], (DEPTH, D_MODEL)),
        "w_in": nrm(ks[3], (DEPTH, D_MODEL, D_IN_PROJ), D_MODEL ** -0.5),
        "gmlp_ln_g": gain(ks[4], (DEPTH, D_GMLP)),
        "gmlp_ln_b": nrm(ks[5], (DEPTH, D_GMLP), 0.02),
        "w_s": nrm(ks[6], (DEPTH, N_GMLP_GROUPS, GMLP_CHUNK, GMLP_CHUNK), GMLP_CHUNK ** -0.5),
        "b_s": 1.0 + 0.1 * jax.random.normal(ks[7], (DEPTH, N_GMLP_GROUPS, GMLP_CHUNK), f32),
        "attn_out_g": gain(ks[8], (DEPTH, D_ATTN)),
        "gmlp_out_g": gain(ks[9], (DEPTH, D_GMLP)),
        "w_o": nrm(ks[10], (DEPTH, D_MIX, D_MODEL), D_MIX ** -0.5),
        "mix_post_g": gain(ks[11], (DEPTH, D_MODEL)),
        "mlp_pre_g": gain(ks[12], (DEPTH, D_MODEL)),
        "w_up": nrm(ks[13], (DEPTH, D_MODEL, D_FF), D_MODEL ** -0.5),
        "w_down": nrm(ks[14], (DEPTH, D_FF, D_MODEL), D_FF ** -0.5),
        "mlp_post_g": gain(ks[15], (DEPTH, D_MODEL)),
        "w_ple": nrm(ks[16], (DEPTH, D_PLE, D_MODEL), D_PLE ** -0.5),
        "w_ple_gate": nrm(ks[17], (DEPTH, D_MODEL, D_MODEL), D_MODEL ** -0.5),
        "b_ple_gate": nrm(ks[18], (DEPTH, D_MODEL), 0.02),
        "ple_post_g": gain(ks[19], (DEPTH, D_MODEL)),
    }


def reference(x, p, mix_pre_g, w_in, gmlp_ln_g, gmlp_ln_b, w_s, b_s, attn_out_g,
              gmlp_out_g, w_o, mix_post_g, mlp_pre_g, w_up, w_down, mlp_post_g,
              w_ple, w_ple_gate, b_ple_gate, ple_post_g):
    B, S, _ = x.shape
    pos = jnp.arange(S, dtype=jnp.int32)
    h = x
    for i in range(DEPTH):
        hn = rms_norm(h, mix_pre_g[i])
        proj = jnp.einsum('bsd,de->bse', hn, w_in[i])
        q, k, v, u, gv = jnp.split(
            proj, [D_ATTN, 2 * D_ATTN, 3 * D_ATTN, 3 * D_ATTN + D_GMLP], axis=-1)
        q = partial_rope(q.reshape(B, S, N_ATTN_HEADS, HEAD_DIM), pos)
        k = partial_rope(k.reshape(B, S, N_ATTN_HEADS, HEAD_DIM), pos)
        v = v.reshape(B, S, N_ATTN_HEADS, HEAD_DIM)
        attn_out = moba_attention(q, k, v)
        gmlp_out = gmlp_spatial_gating(jax.nn.gelu(u, approximate=False),
                                       jax.nn.gelu(gv, approximate=False),
                                       gmlp_ln_g[i], gmlp_ln_b[i], w_s[i], b_s[i])
        mixed = jnp.concatenate([rms_norm(attn_out, attn_out_g[i]),
                                 rms_norm(gmlp_out, gmlp_out_g[i])], axis=-1)
        h = h + rms_norm(jnp.einsum('bse,ed->bsd', mixed, w_o[i]), mix_post_g[i])
        hn = rms_norm(h, mlp_pre_g[i])
        ff = jnp.square(jax.nn.relu(jnp.einsum('bsd,df->bsf', hn, w_up[i])))
        h = h + rms_norm(jnp.einsum('bsf,fd->bsd', ff, w_down[i]), mlp_post_g[i])
        gate = jax.nn.sigmoid(jnp.einsum('bsd,de->bse', h, w_ple_gate[i]) + b_ple_gate[i])
        ple = jnp.einsum('bsp,pd->bsd', p[i], w_ple[i]) * gate
        h = h + rms_norm(ple, ple_post_g[i])
    return h
```

```cpp
#include <hip/hip_runtime.h>
#include <math.h>
#include <stdint.h>

namespace nv {
constexpr int D = 1024, NB = 8, S = 2048;
constexpr int DPLE = 256, H = 8, HD = 64, DA = 512, DG = 512, DIN = 2560, DFF = 4096;
constexpr int MBLK = 256, GCH = 128;
constexpr float EPS = 1e-6f;

__device__ __forceinline__ float wave_sum(float v) {
#pragma unroll
    for (int o = 1; o < 64; o <<= 1) v += __shfl_xor(v, o);
    return v;
}
__device__ __forceinline__ float block_sum(float v, float* red) {
    v = wave_sum(v);
    __syncthreads();
    if ((threadIdx.x & 63) == 0) red[threadIdx.x >> 6] = v;
    __syncthreads();
    return (red[0] + red[1]) + (red[2] + red[3]);
}

__global__ __launch_bounds__(256) void rmsnorm1024(const float* in, const float* g, float* out) {
    __shared__ float red[4];
    const size_t row = blockIdx.x;
    const float4 v = ((const float4*)(in + row * D))[threadIdx.x];
    const float ss = block_sum(v.x * v.x + v.y * v.y + v.z * v.z + v.w * v.w, red);
    const float r = rsqrtf(ss * (1.0f / D) + EPS);
    const float4 gg = ((const float4*)g)[threadIdx.x];
    float4 o; o.x = v.x * r * gg.x; o.y = v.y * r * gg.y; o.z = v.z * r * gg.z; o.w = v.w * r * gg.w;
    ((float4*)(out + row * D))[threadIdx.x] = o;
}
__global__ __launch_bounds__(256) void resid_rmsnorm1024(const float* base, const float* t, const float* g, float* out) {
    __shared__ float red[4];
    const size_t row = blockIdx.x;
    const float4 v = ((const float4*)(t + row * D))[threadIdx.x];
    const float ss = block_sum(v.x * v.x + v.y * v.y + v.z * v.z + v.w * v.w, red);
    const float r = rsqrtf(ss * (1.0f / D) + EPS);
    const float4 gg = ((const float4*)g)[threadIdx.x];
    const float4 b = ((const float4*)(base + row * D))[threadIdx.x];
    float4 o; o.x = b.x + v.x * r * gg.x; o.y = b.y + v.y * r * gg.y; o.z = b.z + v.z * r * gg.z; o.w = b.w + v.w * r * gg.w;
    ((float4*)(out + row * D))[threadIdx.x] = o;
}

template <int EPI>
__global__ __launch_bounds__(256) void gemm_f32(const float* __restrict__ A, const float* __restrict__ Bm, float* __restrict__ C,
                                                const float* __restrict__ bias, const float* __restrict__ aux, int M, int N, int K) {
    __shared__ float As[8][132];
    __shared__ float Bs[8][132];
    const int tid = threadIdx.x, tx = tid & 15, ty = tid >> 4;
    const int m0 = blockIdx.y * 128, n0 = blockIdx.x * 128;
    float acc[8][8];
#pragma unroll
    for (int i = 0; i < 8; ++i)
#pragma unroll
        for (int j = 0; j < 8; ++j) acc[i][j] = 0.f;
    for (int k0 = 0; k0 < K; k0 += 8) {
        const float4 a = *(const float4*)&A[(size_t)(m0 + (tid >> 1)) * K + k0 + (tid & 1) * 4];
        As[(tid & 1) * 4 + 0][tid >> 1] = a.x; As[(tid & 1) * 4 + 1][tid >> 1] = a.y; As[(tid & 1) * 4 + 2][tid >> 1] = a.z; As[(tid & 1) * 4 + 3][tid >> 1] = a.w;
        const float4 b = *(const float4*)&Bm[(size_t)(k0 + (tid >> 5)) * N + n0 + (tid & 31) * 4];
        *(float4*)&Bs[tid >> 5][(tid & 31) * 4] = b;
        __syncthreads();
#pragma unroll
        for (int kk = 0; kk < 8; ++kk) {
            float av[8], bv[8];
            const float4 a0 = *(const float4*)&As[kk][ty * 8], a1 = *(const float4*)&As[kk][ty * 8 + 4];
            const float4 b0 = *(const float4*)&Bs[kk][tx * 8], b1 = *(const float4*)&Bs[kk][tx * 8 + 4];
            av[0] = a0.x; av[1] = a0.y; av[2] = a0.z; av[3] = a0.w; av[4] = a1.x; av[5] = a1.y; av[6] = a1.z; av[7] = a1.w;
            bv[0] = b0.x; bv[1] = b0.y; bv[2] = b0.z; bv[3] = b0.w; bv[4] = b1.x; bv[5] = b1.y; bv[6] = b1.z; bv[7] = b1.w;
#pragma unroll
            for (int i = 0; i < 8; ++i)
#pragma unroll
                for (int j = 0; j < 8; ++j) acc[i][j] = fmaf(av[i], bv[j], acc[i][j]);
        }
        __syncthreads();
    }
#pragma unroll
    for (int i = 0; i < 8; ++i) {
        const size_t r = (size_t)(m0 + ty * 8 + i);
#pragma unroll
        for (int j = 0; j < 8; ++j) {
            const int c = n0 + tx * 8 + j;
            float v = acc[i][j];
            if (EPI == 1) { v = fmaxf(v, 0.f); v = v * v; }
            if (EPI == 2) { v = 1.0f / (1.0f + expf(-(v + bias[c]))); }
            if (EPI == 3) { v = v * aux[r * N + c]; }
            C[r * N + c] = v;
        }
    }
}

__global__ __launch_bounds__(256) void rope_kernel(float* proj) {
    const int idx = blockIdx.x * 256 + threadIdx.x;
    const int j = idx & 7, h = (idx >> 3) & 7, w = (idx >> 6) & 1, s = idx >> 7;
    if (s >= S) return;
    const float inv_freq = powf(500000.0f, -(float)j / 8.0f);
    const float ang = (float)s * inv_freq;
    float sn, cs; sincosf(ang, &sn, &cs);
    float* p = proj + (size_t)s * DIN + w * 512 + h * 64;
    const float x1 = p[j], x2 = p[8 + j];
    p[j] = x1 * cs - x2 * sn;
    p[8 + j] = x2 * cs + x1 * sn;
}
__global__ __launch_bounds__(64) void kmean_kernel(const float* proj, float* kmean) {
    const int h = blockIdx.x >> 3, n = blockIdx.x & 7, d = threadIdx.x;
    float s = 0.f;
    for (int l = 0; l < MBLK; ++l) s += proj[(size_t)(n * MBLK + l) * DIN + 512 + h * 64 + d];
    kmean[(h * 8 + n) * 64 + d] = s * (1.0f / MBLK);
}
__global__ __launch_bounds__(256) void attn_naive(const float* __restrict__ proj, const float* __restrict__ kmean, float* __restrict__ attn_out) {
    const int idx = blockIdx.x * 256 + threadIdx.x;
    const int s = idx & (S - 1), h = idx >> 11;
    const int own = s >> 8;
    float q[64];
    const float* qp = proj + (size_t)s * DIN + h * 64;
#pragma unroll
    for (int d = 0; d < 64; ++d) q[d] = qp[d];
    float gate[8];
#pragma unroll
    for (int n = 0; n < 8; ++n) {
        float g = 0.f;
        const float* km = kmean + (h * 8 + n) * 64;
#pragma unroll
        for (int d = 0; d < 64; ++d) g = fmaf(q[d], km[d], g);
        gate[n] = (n < own) ? g : -1e30f;
    }
    unsigned selmask = 0u;
#pragma unroll
    for (int pick = 0; pick < 3; ++pick) {
        float best = -3e38f; int bi = -1;
#pragma unroll
        for (int n = 0; n < 8; ++n) { const bool ok = (n < own) && !((selmask >> n) & 1u) && (gate[n] > best); if (ok) { best = gate[n]; bi = n; } }
        if (bi >= 0) selmask |= 1u << bi;
    }
#pragma unroll
    for (int d = 0; d < 64; ++d) q[d] *= 0.125f;
    float m = -3e38f, l = 0.f, o[64];
#pragma unroll
    for (int d = 0; d < 64; ++d) o[d] = 0.f;
    for (int n = 0; n <= own; ++n) {
        const bool isown = (n == own);
        if (!isown && !((selmask >> n) & 1u)) continue;
        const int kend = isown ? (s - own * MBLK) : (MBLK - 1);
        for (int kk = 0; kk <= kend; ++kk) {
            const float* kp = proj + (size_t)(n * MBLK + kk) * DIN + 512 + h * 64;
            const float* vp = kp + 512;
            float sc = 0.f;
#pragma unroll
            for (int d = 0; d < 64; ++d) sc = fmaf(q[d], kp[d], sc);
            const float mn = fmaxf(m, sc);
            const float corr = expf(m - mn), p = expf(sc - mn);
            l = l * corr + p;
#pragma unroll
            for (int d = 0; d < 64; ++d) o[d] = fmaf(p, vp[d], o[d] * corr);
            m = mn;
        }
    }
    const float il = 1.0f / l;
    float* op = attn_out + (size_t)s * DA + h * 64;
#pragma unroll
    for (int d = 0; d < 64; ++d) op[d] = o[d] * il;
}

__device__ __forceinline__ float gelu_exact(float x) { return 0.5f * x * (1.0f + erff(x * 0.70710678118654752f)); }
__global__ __launch_bounds__(256) void gelu_ln_kernel(float* proj, const float* ln_g, const float* ln_b) {
    __shared__ float red[4];
    float* row = proj + (size_t)blockIdx.x * DIN;
    const int c0 = threadIdx.x * 2;
    float u0 = gelu_exact(row[1536 + c0]), u1 = gelu_exact(row[1536 + c0 + 1]);
    row[1536 + c0] = u0; row[1536 + c0 + 1] = u1;
    const float g0 = gelu_exact(row[2048 + c0]), g1 = gelu_exact(row[2048 + c0 + 1]);
    const float mean = block_sum(g0 + g1, red) * (1.0f / DG);
    const float d0 = g0 - mean, d1 = g1 - mean;
    const float var = block_sum(d0 * d0 + d1 * d1, red) * (1.0f / DG);
    const float r = rsqrtf(var + EPS);
    row[2048 + c0] = d0 * r * ln_g[c0] + ln_b[c0];
    row[2048 + c0 + 1] = d1 * r * ln_g[c0 + 1] + ln_b[c0 + 1];
}
__global__ __launch_bounds__(256) void gmlp_mix_kernel(const float* __restrict__ proj, const float* __restrict__ w_s, const float* __restrict__ b_s, float* __restrict__ gmlp_out) {
    const int t = blockIdx.x >> 1, c = (blockIdx.x & 1) * 256 + threadIdx.x;
    const int g = c >> 6, ch = t >> 7, tl = t & 127;
    const float* w = w_s + ((size_t)g * GCH + tl) * GCH;
    float acc = 0.f;
    for (int sl = 0; sl <= tl; ++sl) acc = fmaf(w[sl], proj[(size_t)(ch * GCH + sl) * DIN + 2048 + c], acc);
    acc += b_s[g * GCH + tl];
    gmlp_out[(size_t)t * DG + c] = proj[(size_t)t * DIN + 1536 + c] * acc;
}
__global__ __launch_bounds__(256) void mix_norm_kernel(const float* attn_out, const float* gmlp_out, const float* ga, const float* gg, float* mixed) {
    __shared__ float red[4];
    const size_t row = blockIdx.x; const int c0 = threadIdx.x * 2;
    const float a0 = attn_out[row * DA + c0], a1 = attn_out[row * DA + c0 + 1];
    const float ra = rsqrtf(block_sum(a0 * a0 + a1 * a1, red) * (1.0f / DA) + EPS);
    const float m0 = gmlp_out[row * DG + c0], m1 = gmlp_out[row * DG + c0 + 1];
    const float rg = rsqrtf(block_sum(m0 * m0 + m1 * m1, red) * (1.0f / DG) + EPS);
    mixed[row * D + c0] = a0 * ra * ga[c0]; mixed[row * D + c0 + 1] = a1 * ra * ga[c0 + 1];
    mixed[row * D + 512 + c0] = m0 * rg * gg[c0]; mixed[row * D + 512 + c0 + 1] = m1 * rg * gg[c0 + 1];
}
}

extern "C" void kernel_launch(void* const* d_in, const int* in_sizes, int n_in, void* d_out, int out_size, void* d_ws, size_t ws_size, hipStream_t stream) {
    using namespace nv;
    const float* x = (const float*)d_in[0];
    const float* p = (const float*)d_in[1];
    const float* mix_pre_g = (const float*)d_in[2];
    const float* w_in = (const float*)d_in[3];
    const float* gmlp_ln_g = (const float*)d_in[4];
    const float* gmlp_ln_b = (const float*)d_in[5];
    const float* w_s = (const float*)d_in[6];
    const float* b_s = (const float*)d_in[7];
    const float* attn_out_g = (const float*)d_in[8];
    const float* gmlp_out_g = (const float*)d_in[9];
    const float* w_o = (const float*)d_in[10];
    const float* mix_post_g = (const float*)d_in[11];
    const float* mlp_pre_g = (const float*)d_in[12];
    const float* w_up = (const float*)d_in[13];
    const float* w_down = (const float*)d_in[14];
    const float* mlp_post_g = (const float*)d_in[15];
    const float* w_ple = (const float*)d_in[16];
    const float* w_ple_gate = (const float*)d_in[17];
    const float* b_ple_gate = (const float*)d_in[18];
    const float* ple_post_g = (const float*)d_in[19];
    float* out = (float*)d_out;
    float* ws = (float*)d_ws;
    const size_t MiBf = (1u << 20) / 4;
    float* hn = ws;
    float* proj = ws + 8 * MiBf;
    float* kmean = ws + 28 * MiBf;
    float* attn_o = ws + 29 * MiBf;
    float* gmlp_o = ws + 33 * MiBf;
    float* mixed = ws + 37 * MiBf;
    float* tmp = ws + 45 * MiBf;
    float* ff = ws + 53 * MiBf;
    float* gate = ws + 85 * MiBf;
    for (int b = 0; b < NB; ++b) {
        const float* xb = x + (size_t)b * S * D;
        const float* pb = p + (size_t)b * S * DPLE;
        float* ob = out + (size_t)b * S * D;
        rmsnorm1024<<<S, 256, 0, stream>>>(xb, mix_pre_g, hn);
        gemm_f32<0><<<dim3(DIN / 128, S / 128), 256, 0, stream>>>(hn, w_in, proj, nullptr, nullptr, S, DIN, D);
        rope_kernel<<<S * 128 / 256, 256, 0, stream>>>(proj);
        kmean_kernel<<<64, 64, 0, stream>>>(proj, kmean);
        attn_naive<<<S * H / 256, 256, 0, stream>>>(proj, kmean, attn_o);
        gelu_ln_kernel<<<S, 256, 0, stream>>>(proj, gmlp_ln_g, gmlp_ln_b);
        gmlp_mix_kernel<<<S * 2, 256, 0, stream>>>(proj, w_s, b_s, gmlp_o);
        mix_norm_kernel<<<S, 256, 0, stream>>>(attn_o, gmlp_o, attn_out_g, gmlp_out_g, mixed);
        gemm_f32<0><<<dim3(D / 128, S / 128), 256, 0, stream>>>(mixed, w_o, tmp, nullptr, nullptr, S, D, D);
        resid_rmsnorm1024<<<S, 256, 0, stream>>>(xb, tmp, mix_post_g, ob);
        rmsnorm1024<<<S, 256, 0, stream>>>(ob, mlp_pre_g, hn);
        gemm_f32<1><<<dim3(DFF / 128, S / 128), 256, 0, stream>>>(hn, w_up, ff, nullptr, nullptr, S, DFF, D);
        gemm_f32<0><<<dim3(D / 128, S / 128), 256, 0, stream>>>(ff, w_down, tmp, nullptr, nullptr, S, D, DFF);
        resid_rmsnorm1024<<<S, 256, 0, stream>>>(ob, tmp, mlp_post_g, ob);
        gemm_f32<2><<<dim3(D / 128, S / 128), 256, 0, stream>>>(ob, w_ple_gate, gate, b_ple_gate, nullptr, S, D, D);
        gemm_f32<3><<<dim3(D / 128, S / 128), 256, 0, stream>>>(pb, w_ple, tmp, nullptr, gate, S, D, DPLE);
        resid_rmsnorm1024<<<S, 256, 0, stream>>>(ob, tmp, ple_post_g, ob);
    }
}
```
